# Optimizing an MI355X kernel written in HIP

```python
import math
import jax, jax.numpy as jnp
from jax import lax
import numpy as np

D_MODEL = 1024
BATCH = 4
SEQ = 4096
DEPTH = 4
DEC_BATCH = 32
DEC_SEQ = 1
PAST_LEN = 8192
PAGE_SIZE = 128

N_A_LAYERS = DEPTH // 2
N_B_LAYERS = DEPTH - N_A_LAYERS
POOL_WINDOWS = (2, 4, 8, 16)
N_POOL_GROUPS = len(POOL_WINDOWS)
POOL_GROUP = D_MODEL // N_POOL_GROUPS
POOL_STATE = max(POOL_WINDOWS) - 1
BRANCHES = ((128, 1), (512, 4), (2048, 16))
N_BRANCH = len(BRANCHES)
HEADS = 8
HEAD_DIM = D_MODEL // HEADS
ATT_WIDTH = HEADS * HEAD_DIM
D_FF = 4 * D_MODEL
NUM_BUCKETS = 32
MAX_DISTANCE = 2048
Q_BLOCK = 128
EPS = 1e-6

kernel_name = "yoco_pool_dilated_attn_step"


def rmsnorm(x, g):
    xf = x.astype(jnp.float32)
    y = xf * lax.rsqrt(jnp.mean(xf * xf, axis=-1, keepdims=True) + EPS)
    return (y * g.astype(jnp.float32)).astype(x.dtype)


def t5_bucket(dist):
    max_exact = NUM_BUCKETS // 2
    df = jnp.maximum(dist, 1).astype(jnp.float32)
    large = max_exact + (jnp.log(df / max_exact) / math.log(MAX_DISTANCE / max_exact)
                         * (NUM_BUCKETS - max_exact)).astype(jnp.int32)
    large = jnp.minimum(large, NUM_BUCKETS - 1)
    return jnp.where(dist < max_exact, dist, large)


def branch_biases(rel_bias):
    out = []
    for g, (w, d) in enumerate(BRANCHES):
        dist = jnp.arange(w // d + 1, dtype=jnp.int32) * d
        out.append(rel_bias[t5_bucket(dist)][:, g * HEADS:(g + 1) * HEADS])
    return out


def pool_mix(h, buf, pos0, w_pool, scale):
    B, T, D = h.shape
    xp = jnp.concatenate([buf.astype(h.dtype), h], axis=1).astype(jnp.float32)
    cs = jnp.concatenate([jnp.zeros_like(xp[:, :1]), jnp.cumsum(xp, axis=1)], axis=1)
    pos = pos0 + jnp.arange(T)
    hi = cs[:, POOL_STATE + 1:]
    parts = []
    for g, w in enumerate(POOL_WINDOWS):
        sl = slice(g * POOL_GROUP, (g + 1) * POOL_GROUP)
        lo = cs[:, POOL_STATE + 1 - w:POOL_STATE + 1 - w + T, sl]
        cnt = jnp.minimum(pos + 1, w).astype(jnp.float32)[None, :, None]
        parts.append((hi[..., sl] - lo) / cnt - xp[:, POOL_STATE:, sl])
    pooled = jnp.stack(parts, axis=2).astype(h.dtype)
    y = jnp.einsum('btgc,gce->btge', pooled, w_pool).reshape(B, T, D) * scale
    new_buf = xp[:, -POOL_STATE:].astype(h.dtype)
    return y, new_buf


def branch_attend(q, k_ctx, v_ctx, q_idx, dil, n_keys, bias):
    idx = q_idx[:, None] - dil * jnp.arange(n_keys)[None, :]
    valid = idx >= 0
    idx = jnp.maximum(idx, 0)
    k_g = k_ctx[:, idx]
    v_g = v_ctx[:, idx]
    s = jnp.einsum('bqhd,bqkhd->bqhk', q, k_g).astype(jnp.float32) * (HEAD_DIM ** -0.5)
    s = s + bias.T.astype(jnp.float32)[None, None]
    s = jnp.where(valid[None, :, None, :], s, -jnp.inf)
    lse = jax.nn.logsumexp(s, axis=-1)
    p = jnp.exp(s - lse[..., None])
    o = jnp.einsum('bqhk,bqkhd->bqhd', p.astype(v_g.dtype), v_g)
    return o, lse


def dilated_mix(q3, ctxs, q_idxs, biases):
    outs, lses = [], []
    for g, (w, d) in enumerate(BRANCHES):
        o, l = branch_attend(q3[:, :, g], ctxs[g][0], ctxs[g][1], q_idxs[g], d, w // d + 1, biases[g])
        outs.append(o)
        lses.append(l)
    wts = jax.nn.softmax(jnp.stack(lses, axis=0), axis=0)
    return jnp.einsum('gbqh,gbqhd->bqhd', wts.astype(outs[0].dtype), jnp.stack(outs, axis=0))


def dilated_attention(q3, ctxs, offsets, biases):
    B, T = q3.shape[:2]
    if T >= Q_BLOCK and T % Q_BLOCK == 0:
        nb = T // Q_BLOCK
        qs = q3.reshape((B, nb, Q_BLOCK) + q3.shape[2:]).swapaxes(0, 1)

        def block(args):
            qb, start = args
            idxs = [off + start + jnp.arange(Q_BLOCK) for off in offsets]
            return dilated_mix(qb, ctxs, idxs, biases)

        out = lax.map(block, (qs, jnp.arange(nb) * Q_BLOCK))
        return out.swapaxes(0, 1).reshape(B, T, HEADS, HEAD_DIM)
    idxs = [off + jnp.arange(T) for off in offsets]
    return dilated_mix(q3, ctxs, idxs, biases)


def trunk(x, pool_state, kv_caches, pos0, norm_mix, pool_w, pool_scale, norm_mlp, mlp_in, mlp_out,
          norm_kv, w_kv, w_q, w_o, biases, norm_final):
    B, T, D = x.shape
    new_pool, new_kv = [], []
    ctxs, offsets = [], []
    for l in range(DEPTH):
        h = rmsnorm(x, norm_mix[l])
        if l < N_A_LAYERS:
            y, nbuf = pool_mix(h, pool_state[l], pos0, pool_w[l], pool_scale[l])
            new_pool.append(nbuf)
        else:
            if l == N_A_LAYERS:
                kv = (rmsnorm(x, norm_kv) @ w_kv).reshape(B, T, N_BRANCH, 2, HEADS, HEAD_DIM)
                for g, (w, d) in enumerate(BRANCHES):
                    cache = kv_caches[g].astype(kv.dtype)
                    full = jnp.concatenate([cache, kv[:, :, g]], axis=1)
                    ctxs.append((full[:, :, 0], full[:, :, 1]))
                    offsets.append(cache.shape[1])
                    new_kv.append(kv[:, max(T - w, 0):, g])
            lb = l - N_A_LAYERS
            q3 = (h @ w_q[lb]).reshape(B, T, N_BRANCH, HEADS, HEAD_DIM)
            o = dilated_attention(q3, ctxs, offsets, biases)
            y = o.reshape(B, T, ATT_WIDTH) @ w_o[lb]
        x = x + y
        h = rmsnorm(x, norm_mlp[l])
        x = x + jnp.square(jax.nn.relu(h @ mlp_in[l])) @ mlp_out[l]
    return rmsnorm(x, norm_final), jnp.stack(new_pool, axis=0), new_kv


def setup_inputs(seed: int = 0) -> dict:
    key = jax.random.key(seed)
    ks = jax.random.split(key, 24)
    f32 = jnp.float32
    nrm = lambda k, shape: jax.random.normal(k, shape, f32)
    win = [min(w, PAST_LEN) for (w, d) in BRANCHES]
    return {
        "x_prompt": nrm(ks[0], (BATCH, SEQ, D_MODEL)),
        "x_sample": nrm(ks[1], (DEC_BATCH, DEC_SEQ, D_MODEL)),
        "state_pool": nrm(ks[2], (N_A_LAYERS, DEC_BATCH, POOL_STATE, D_MODEL)),
        "cache_kv_w128": nrm(ks[3], (DEC_BATCH, win[0], 2, HEADS, HEAD_DIM)),
        "cache_kv_w512": nrm(ks[4], (DEC_BATCH, win[1], 2, HEADS, HEAD_DIM)),
        "cache_kv_w2048": nrm(ks[5], (DEC_BATCH, win[2], 2, HEADS, HEAD_DIM)),
        "norm_mix": 1.0 + 0.05 * nrm(ks[6], (DEPTH, D_MODEL)),
        "pool_w": nrm(ks[7], (N_A_LAYERS, N_POOL_GROUPS, POOL_GROUP, POOL_GROUP)) * POOL_GROUP ** -0.5,
        "pool_scale": 1.0 + 0.05 * nrm(ks[8], (N_A_LAYERS, D_MODEL)),
        "norm_mlp": 1.0 + 0.05 * nrm(ks[9], (DEPTH, D_MODEL)),
        "mlp_in": nrm(ks[10], (DEPTH, D_MODEL, D_FF)) * D_MODEL ** -0.5,
        "mlp_out": nrm(ks[11], (DEPTH, D_FF, D_MODEL)) * D_FF ** -0.5,
        "norm_kv": 1.0 + 0.05 * nrm(ks[12], (D_MODEL,)),
        "w_kv": nrm(ks[13], (D_MODEL, N_BRANCH * 2 * ATT_WIDTH)) * D_MODEL ** -0.5,
        "w_q": nrm(ks[14], (N_B_LAYERS, D_MODEL, N_BRANCH * ATT_WIDTH)) * D_MODEL ** -0.5,
        "w_o": nrm(ks[15], (N_B_LAYERS, ATT_WIDTH, D_MODEL)) * ATT_WIDTH ** -0.5,
        "rel_bias": 0.2 * nrm(ks[16], (NUM_BUCKETS, N_BRANCH * HEADS)),
        "norm_final": 1.0 + 0.05 * nrm(ks[17], (D_MODEL,)),
    }


def reference(x_prompt, x_sample, state_pool, cache_kv_w128, cache_kv_w512, cache_kv_w2048,
              norm_mix, pool_w, pool_scale, norm_mlp, mlp_in, mlp_out, norm_kv, w_kv, w_q, w_o,
              rel_bias, norm_final):
    biases = branch_biases(rel_bias)
    weights = (norm_mix, pool_w, pool_scale, norm_mlp, mlp_in, mlp_out, norm_kv, w_kv, w_q, w_o, biases, norm_final)
    Bp = x_prompt.shape[0]
    pool0 = jnp.zeros((N_A_LAYERS, Bp, POOL_STATE, D_MODEL), x_prompt.dtype)
    empty = [jnp.zeros((Bp, 0, 2, HEADS, HEAD_DIM), x_prompt.dtype) for _ in BRANCHES]
    y_prompt, pool_p, kv_p = trunk(x_prompt, pool0, empty, 0, *weights)
    y_sample, pool_s, kv_s = trunk(x_sample, state_pool, [cache_kv_w128, cache_kv_w512, cache_kv_w2048],
                                   PAST_LEN, *weights)
    return (y_prompt, y_sample, pool_p, pool_s, kv_p[0], kv_s[0], kv_p[1], kv_s[1], kv_p[2], kv_s[2])
```

```cpp
#include <hip/hip_runtime.h>
#include <cstdio>
#include <cstdint>

#define LAS __attribute__((address_space(3)))
#define GAS __attribute__((address_space(1)))
typedef unsigned short bf16_t;
typedef short bf16x8 __attribute__((ext_vector_type(8)));
typedef short bf16x4 __attribute__((ext_vector_type(4)));
typedef float f32x4 __attribute__((ext_vector_type(4)));
typedef float f32x2 __attribute__((ext_vector_type(2)));
typedef unsigned u32x4 __attribute__((ext_vector_type(4)));
typedef unsigned u32x2 __attribute__((ext_vector_type(2)));

#ifndef KMASK
#define KMASK 0x3ff
#endif
#define KON(k) ((KMASK >> (k)) & 1)
#ifndef MK_PER_PHASE
#define MK_PER_PHASE 1
#endif

constexpr int D = 1024, NB = 4, T = 4096, M = NB * T, SB = 32, FF = 4096, NH = 8, HD = 128;
constexpr int NQKV = 9216;
constexpr float EPS = 1e-6f;
constexpr float QSCALE = 0.08838834764831845f * 1.4426950408889634f;
constexpr float LOG2E = 1.4426950408889634f;
constexpr int NPHASE = 21;

constexpr size_t OUT_Y = 0, OUT_YS = 16777216, OUT_PP = 16809984, OUT_PS = 16932864, OUT_KV128P = 17915904, OUT_KV128S = 18964480,
                 OUT_KV512P = 19030016, OUT_KV512S = 23224320, OUT_KV2048P = 23289856, OUT_KV2048S = 40067072, OUT_TOTAL = 40132608;

constexpr size_t MiB = 1u << 20;
constexpr size_t WS_CTL = 0, CTL_ZERO_BYTES = 1 * MiB;
constexpr size_t WS_WP = 1 * MiB;
constexpr size_t WS_W1 = 2 * MiB;
constexpr size_t WS_W2 = 34 * MiB;
constexpr size_t WS_WQKV = 66 * MiB;
constexpr size_t WS_WQ3 = 84 * MiB;
constexpr size_t WS_WO = 90 * MiB;
constexpr size_t WS_BIAS = 94 * MiB;
constexpr size_t WS_RSA = 95 * MiB;
constexpr size_t WS_RSB = 95 * MiB + 512 * 1024;
constexpr size_t WS_SMP = 96 * MiB;
constexpr size_t WS_X = 98 * MiB;
constexpr size_t WS_XB = 162 * MiB;
constexpr size_t WS_PL = 194 * MiB;
constexpr size_t WS_HID = 226 * MiB;
constexpr size_t WS_QA = 354 * MiB;
constexpr size_t WS_KA = 450 * MiB;
constexpr size_t WS_VA = 546 * MiB;
constexpr size_t WS_OG = 642 * MiB;
constexpr size_t WS_LG = 706 * MiB;
constexpr size_t WS_END = 708 * MiB;
constexpr size_t SM_XA = 0, SM_XBF = 128 * 1024, SM_XBB = 256 * 1024  , SM_PL = 320 * 1024, SM_HID = 384 * 1024  ,
                 SM_Q = 640 * 1024  , SM_O = 1024 * 1024  ;

constexpr int CW_BAR = 4096;

constexpr int RING_BYTES = 131072;
constexpr int AUX_OFF = RING_BYTES;
constexpr int LDSCTL_OFF = RING_BYTES + 4096, MISC_OFF = LDSCTL_OFF + 320;
constexpr int LDS_BYTES = 147456;

#define LDS_WAIT() asm volatile("s_waitcnt lgkmcnt(0)" ::: "memory")
#define VM_WAIT() asm volatile("s_waitcnt vmcnt(0)" ::: "memory")
#define RLX_AGENT __ATOMIC_RELAXED, __HIP_MEMORY_SCOPE_AGENT

__device__ __forceinline__ unsigned f2bf(float f) { unsigned u = __builtin_bit_cast(unsigned, f); return (u + 0x7fffu + ((u >> 16) & 1u)) >> 16; }
__device__ __forceinline__ unsigned pk2(float lo, float hi) { return f2bf(lo) | (f2bf(hi) << 16); }
__device__ __forceinline__ float bf2f(unsigned short h) { return __builtin_bit_cast(float, (unsigned)h << 16); }
__device__ __forceinline__ float bflo(unsigned w) { return __builtin_bit_cast(float, w << 16); }
__device__ __forceinline__ float bfhi(unsigned w) { return __builtin_bit_cast(float, w & 0xffff0000u); }
__device__ __forceinline__ float wave_sum(float v) {
#pragma unroll
    for (int o = 1; o < 64; o <<= 1) v += __shfl_xor(v, o);
    return v;
}
__device__ __forceinline__ float wave_max(float v) {
#pragma unroll
    for (int o = 1; o < 64; o <<= 1) v = fmaxf(v, __shfl_xor(v, o));
    return v;
}

namespace pg8 {
constexpr int BM = 256, BK = 64, HALF = 128, HTB = HALF * BK * 2, STAGE_BYTES = 8 * HTB, NXCD = 8, WGM = 8;
__host__ __device__ __forceinline__ int lds_byte(int r, int c) { const int st = (r >> 4) * 2 + (c >> 5), rr = r & 15, cc = c & 31, ob = rr * 64 + cc * 2; return st * 1024 + (ob ^ (((ob >> 9) & 1) << 5)); }
__host__ __device__ __forceinline__ void stage_rc(int b, int& R, int& C) { const int st = b / 1024, sb = b % 1024, swz = sb ^ (((sb >> 9) & 1) << 5); R = (st >> 1) * 16 + swz / 64; C = (st & 1) * 32 + (swz % 64) / 2; }
__host__ __device__ __forceinline__ int perm32(int rho) { const int n = rho >> 4, i = rho & 15; return 8 * (i >> 2) + 4 * n + (i & 3); }

struct Unit { int pm, pn; };
struct Gemm { const bf16_t* A; const bf16_t* Bt; int M, N, K, lda, ldb, acol; };

struct StaticOrder {
    int nM, nN, nwg, G, c;
    __host__ __device__ void init(int M_, int N_, int G_, int c_) { nM = M_ / BM; nN = N_ / BM; nwg = nM * nN; G = G_; c = c_; }
    __host__ __device__ bool next(int i, Unit& u) const {
        const long L = (long)i * G + c; if (L >= nwg) return false;
        int wgid = (int)L; { const int q = nwg / NXCD, r = nwg % NXCD, xcd = wgid % NXCD, off = wgid / NXCD; wgid = (xcd < r ? xcd * (q + 1) : r * (q + 1) + (xcd - r) * q) + off; }
        const int nig = WGM * nN, gid = wgid / nig, fm = gid * WGM, gsz = (nM - fm) < WGM ? (nM - fm) : WGM;
        u.pm = fm + ((wgid % nig) % gsz); u.pn = (wgid % nig) / gsz; return true;
    }
};

__device__ __forceinline__ unsigned cvt_pk_bf16(float lo, float hi) { unsigned r; asm volatile("v_cvt_pk_bf16_f32 %0, %1, %2" : "=v"(r) : "v"(lo), "v"(hi)); return r; }


struct EpiRelu2 {
    static constexpr bool PERM = true, AFTER_DRAIN = false;
    bf16_t* O; int ldc;
    __device__ __forceinline__ void operator()(const f32x4 (&acc)[2][2][4][2], const Unit& u, int wr, int wc, int fr, int fq) const {
        const int row0 = u.pm * BM + wr * 64 + fr, col0 = u.pn * BM + wc * 32 + 8 * fq;
#pragma unroll
        for (int ai = 0; ai < 2; ++ai)
#pragma unroll
            for (int m = 0; m < 4; ++m) { bf16_t* rowp = O + (size_t)(row0 + ai * HALF + m * 16) * ldc + col0;
#pragma unroll
                for (int bj = 0; bj < 2; ++bj) { f32x4 v0 = acc[ai][bj][m][0], v1 = acc[ai][bj][m][1];
                    v0 = __builtin_elementwise_max(v0, (f32x4){0.f, 0.f, 0.f, 0.f}); v1 = __builtin_elementwise_max(v1, (f32x4){0.f, 0.f, 0.f, 0.f});
                    v0 = v0 * v0; v1 = v1 * v1;
                    u32x4 w; w.x = cvt_pk_bf16(v0[0], v0[1]); w.y = cvt_pk_bf16(v0[2], v0[3]); w.z = cvt_pk_bf16(v1[0], v1[1]); w.w = cvt_pk_bf16(v1[2], v1[3]);
                    *(u32x4*)(rowp + bj * HALF) = w; } }
    }
};

struct EpiQKV {
    static constexpr bool PERM = true, AFTER_DRAIN = false;
    const float* rs;
    unsigned char* ws;
    float* out;
    int pn_off;
    __device__ __forceinline__ void operator()(const f32x4 (&acc)[2][2][4][2], const Unit& u, int wr, int wc, int fr, int fq) const {
        const int pnn = u.pn + pn_off;
        int g, kvsel, h0; bf16_t* dst;
        if (pnn < 24) { g = pnn >> 3; kvsel = (pnn >> 2) & 1; h0 = (pnn & 3) * 2; }
        else { const int pq = pnn - 24; g = pq >> 2; kvsel = -1; h0 = (pq & 3) * 2; }
        dst = (bf16_t*)(ws + (kvsel < 0 ? WS_QA : (kvsel ? WS_VA : WS_KA)));
        const int dsh = 2 * g;
        const int win = 128 << (2 * g);
        float* okv = out + (g == 0 ? OUT_KV128P : (g == 1 ? OUT_KV512P : OUT_KV2048P)) + (kvsel > 0 ? 1024 : 0) + h0 * HD;
        dst += (size_t)(g * NB * NH + h0) * T * HD;
        const int dim0 = wc * 32 + 8 * fq;
#pragma unroll
        for (int ai = 0; ai < 2; ++ai)
#pragma unroll
            for (int m = 0; m < 4; ++m) {
                const int r = u.pm * BM + ai * HALF + wr * 64 + m * 16 + fr;
                const float ss = (rs[r] + rs[M + r]) + (rs[2 * M + r] + rs[3 * M + r]);
                const float rinv = 1.0f / sqrtf(ss * (1.0f / D) + EPS);
                const int b = r >> 12, t = r & 4095;
                const int slot = ((t & ((1 << dsh) - 1)) << (12 - dsh)) + (t >> dsh);
                const unsigned doff = (unsigned)((b * NH * T + slot) * HD + dim0);
                const bool wr_out = kvsel >= 0 && t >= T - win;
                const unsigned ooff = (unsigned)((b * win + (t - (T - win))) * 2048 + dim0);
#pragma unroll
                for (int bj = 0; bj < 2; ++bj) {
                    const f32x4 v0 = acc[ai][bj][m][0] * rinv, v1 = acc[ai][bj][m][1] * rinv;
                    u32x4 w; w.x = cvt_pk_bf16(v0[0], v0[1]); w.y = cvt_pk_bf16(v0[2], v0[3]); w.z = cvt_pk_bf16(v1[0], v1[1]); w.w = cvt_pk_bf16(v1[2], v1[3]);
                    *(u32x4*)(dst + doff + bj * (T * HD)) = w;
                    if (wr_out) { float* o = okv + ooff + bj * HD; *(f32x4*)o = v0; *(f32x4*)(o + 4) = v1; }
                }
                if (m & 1) asm volatile("" ::: "memory");
            }
    }
};

struct EpiRes {
    static constexpr bool PERM = false, AFTER_DRAIN = true;
    const float* base; float* out; bf16_t* xb;
    const float* rs_in;
    float* rs_out;
    __device__ __forceinline__ void fused(f32x4 (&acc)[2][2][4][2], const Unit& u, int wr, int wc, int fr, int fq, LAS unsigned char* lds, int wid, int lane) const {
        LAS float* P = (LAS float*)lds;
        const int col0 = u.pn * BM + wc * 32 + 4 * fq;
#pragma unroll
        for (int ai = 0; ai < 2; ++ai)
#pragma unroll
            for (int m = 0; m < 4; ++m) {
                const int rl = ai * HALF + wr * 64 + m * 16 + fr, r = u.pm * BM + rl;
                float rsc = 1.f;
                if (rs_in) { const float ss = (rs_in[r] + rs_in[M + r]) + (rs_in[2 * M + r] + rs_in[3 * M + r]); rsc = 1.0f / (ss * (1.0f / D) + EPS); }
                const size_t off = (size_t)r * D + col0;
                float sq = 0.f;
#pragma unroll
                for (int bj = 0; bj < 2; ++bj)
#pragma unroll
                    for (int n = 0; n < 2; ++n) {
                        const f32x4 bs = *(const f32x4*)(base + off + bj * HALF + n * 16);
                        const f32x4 v = bs + acc[ai][bj][m][n] * rsc;
                        *(f32x4*)(out + off + bj * HALF + n * 16) = v;
                        u32x2 w; w.x = cvt_pk_bf16(v[0], v[1]); w.y = cvt_pk_bf16(v[2], v[3]);
                        *(u32x2*)(xb + off + bj * HALF + n * 16) = w;
                        sq += (v[0] * v[0] + v[1] * v[1]) + (v[2] * v[2] + v[3] * v[3]);
                    }
                sq += __shfl_xor(sq, 16); sq += __shfl_xor(sq, 32);
                if (fq == 0) P[rl * 4 + wc] = sq;
                if (m & 1) asm volatile("" ::: "memory");
            }
        asm volatile("s_waitcnt lgkmcnt(0)" ::: "memory"); __builtin_amdgcn_s_barrier(); asm volatile("" ::: "memory");
        const int tid = wid * 64 + lane;
        if (tid < 256) rs_out[(size_t)u.pn * M + u.pm * BM + tid] = (P[tid * 4 + 0] + P[tid * 4 + 1]) + (P[tid * 4 + 2] + P[tid * 4 + 3]);
        asm volatile("s_waitcnt lgkmcnt(0)" ::: "memory"); __builtin_amdgcn_s_barrier(); asm volatile("" ::: "memory");
    }
};

template <class Epi, class Sched, bool ALIGN_EPI = false, bool SP2 = false>
__device__ __forceinline__ void gemm_phase(LAS unsigned char* lds, const int tid, const Gemm g, const Sched& S, const Epi& E) {
    const int wid = __builtin_amdgcn_readfirstlane(tid >> 6), lane = tid & 63, wr = wid >> 2, wc = wid & 3, fr = lane & 15, fq = lane >> 4;
    const int K = g.K, nt = K / BK;
    unsigned voffA[2], voffB[2];
#pragma unroll
    for (int i = 0; i < 2; ++i) { int R, C; stage_rc(tid * 16 + i * 8192, R, C); const int Rb = Epi::PERM ? ((R & ~31) + perm32(R & 31)) : R;
        voffA[i] = (unsigned)(R * g.lda + C) * 2u; voffB[i] = (unsigned)(Rb * g.ldb + C) * 2u; }
    const size_t kstep = (size_t)(BK * 2);
    const size_t hstepA = (size_t)HALF * g.lda * 2, hstepB = (size_t)HALF * g.ldb * 2;
    const size_t tstepA = 2 * hstepA, tstepB = 2 * hstepB, cstepA = (size_t)g.acol * 2;
    const unsigned ldsw = (unsigned)wid * 1024u;
    const int aoff = lds_byte(wr * 64 + fr, fq * 8), boff = lds_byte(wc * 32 + fr, fq * 8);
#define PG8_SA(b, h) (((b) * 2 + (h)) * HTB)
#define PG8_SB(b, h) ((4 + (b) * 2 + (h)) * HTB)
#define PG8_STAGE(bufoff, gbase, voff) do { _Pragma("unroll") for (int _i = 0; _i < 2; ++_i) \
        __builtin_amdgcn_global_load_lds((const unsigned*)((const char*)(gbase) + (voff)[_i]), (LAS unsigned*)(lds + (bufoff) + ldsw + _i * 8192), 16, 0, 0); } while (0)
#define PG8_LDA(dst, b, h) do { _Pragma("unroll") for (int m = 0; m < 4; ++m) _Pragma("unroll") for (int k = 0; k < 2; ++k) dst[m][k] = *(const LAS bf16x8*)(lds + PG8_SA(b, h) + aoff + m * 2048 + k * 1024); } while (0)
#define PG8_LDB(dst, b, h) do { _Pragma("unroll") for (int n = 0; n < 2; ++n) _Pragma("unroll") for (int k = 0; k < 2; ++k) dst[n][k] = *(const LAS bf16x8*)(lds + PG8_SB(b, h) + boff + n * 2048 + k * 1024); } while (0)
#define PG8_MMA(ai, bj, At, Bt) do { __builtin_amdgcn_s_setprio(1); _Pragma("unroll") for (int m = 0; m < 4; ++m) _Pragma("unroll") for (int n = 0; n < 2; ++n) _Pragma("unroll") for (int k = 0; k < 2; ++k) \
        acc[ai][bj][m][n] = __builtin_amdgcn_mfma_f32_16x16x32_bf16(Bt[n][k], At[m][k], acc[ai][bj][m][n], 0, 0, 0); __builtin_amdgcn_s_setprio(0); } while (0)
#define PG8_WAIT_V(n) asm volatile("s_waitcnt vmcnt(" #n ")" ::: "memory")
#define PG8_WAIT_L(n) asm volatile("s_waitcnt lgkmcnt(" #n ")" ::: "memory")
#define PG8_BAR __builtin_amdgcn_s_barrier()
#define PG8_SCHED __builtin_amdgcn_sched_barrier(0)
    Unit cur, nxt; int ui = 0;
    if (!S.next(0, cur)) return;
    f32x4 acc[2][2][4][2];
#pragma unroll
    for (int a = 0; a < 2; ++a)
#pragma unroll
        for (int b = 0; b < 2; ++b)
#pragma unroll
            for (int m = 0; m < 4; ++m)
#pragma unroll
                for (int n = 0; n < 2; ++n) acc[a][b][m][n] = (f32x4){0.f, 0.f, 0.f, 0.f};
    bf16x8 At[4][2], B0[2][2], B1[2][2];
    const char* cA = (const char*)g.A + (size_t)cur.pm * tstepA + (size_t)cur.pn * cstepA; const char* cB = (const char*)g.Bt + (size_t)cur.pn * tstepB;
    if constexpr (SP2) {
        PG8_STAGE(PG8_SB(0, 0), cB, voffB); PG8_STAGE(PG8_SB(0, 1), cB + hstepB, voffB); PG8_STAGE(PG8_SA(0, 0), cA, voffA); PG8_STAGE(PG8_SA(0, 1), cA + hstepA, voffA);
        if (wr == 1) PG8_BAR;
        PG8_WAIT_V(2); PG8_BAR;
        PG8_STAGE(PG8_SB(1, 0), cB + kstep, voffB); PG8_STAGE(PG8_SA(1, 0), cA + kstep, voffA); PG8_STAGE(PG8_SB(1, 1), cB + hstepB + kstep, voffB);
        PG8_WAIT_V(6); PG8_BAR;
    } else {
        PG8_STAGE(PG8_SB(0, 0), cB, voffB); PG8_STAGE(PG8_SA(0, 0), cA, voffA); PG8_STAGE(PG8_SB(0, 1), cB + hstepB, voffB); PG8_STAGE(PG8_SA(0, 1), cA + hstepA, voffA);
        if (wr == 1) PG8_BAR;
        PG8_WAIT_V(4); PG8_BAR;
        PG8_STAGE(PG8_SB(1, 0), cB + kstep, voffB); PG8_STAGE(PG8_SA(1, 0), cA + kstep, voffA); PG8_STAGE(PG8_SB(1, 1), cB + hstepB + kstep, voffB);
        PG8_WAIT_V(6); PG8_BAR;
    }
    for (;;) {
        const bool has_next = S.next(ui + 1, nxt);
        const char* nA = has_next ? (const char*)g.A + (size_t)nxt.pm * tstepA + (size_t)nxt.pn * cstepA : cA; const char* nB = has_next ? (const char*)g.Bt + (size_t)nxt.pn * tstepB : cB;
        for (int t = 0; t < nt; t += 2) {
            const bool last = (t == nt - 2);
            const char* a1 = cA + (size_t)(t + 1) * kstep;
            const char* a2 = last ? nA : cA + (size_t)(t + 2) * kstep; const char* b2 = last ? nB : cB + (size_t)(t + 2) * kstep;
            const char* a3 = a2 + kstep; const char* b3 = b2 + kstep;
            if constexpr (SP2) {
            PG8_LDB(B0, 0, 0); PG8_LDB(B1, 0, 1); PG8_SCHED; PG8_LDA(At, 0, 0); PG8_STAGE(PG8_SA(1, 1), a1 + hstepA, voffA);
            PG8_WAIT_V(8); PG8_WAIT_L(0); PG8_BAR; PG8_MMA(0, 0, At, B0); PG8_MMA(0, 1, At, B1); PG8_BAR; PG8_SCHED;
            PG8_LDA(At, 0, 1); PG8_STAGE(PG8_SB(0, 0), b2, voffB); PG8_STAGE(PG8_SB(0, 1), b2 + hstepB, voffB); PG8_STAGE(PG8_SA(0, 0), a2, voffA);
            PG8_WAIT_V(8); PG8_WAIT_L(0); PG8_BAR; PG8_MMA(1, 0, At, B0); PG8_MMA(1, 1, At, B1); PG8_BAR; PG8_SCHED;
            PG8_LDB(B0, 1, 0); PG8_LDB(B1, 1, 1); PG8_SCHED; PG8_LDA(At, 1, 0); PG8_STAGE(PG8_SA(0, 1), a2 + hstepA, voffA);
            PG8_WAIT_V(8); PG8_WAIT_L(0); PG8_BAR; PG8_MMA(0, 0, At, B0); PG8_MMA(0, 1, At, B1); PG8_BAR; PG8_SCHED;
            PG8_LDA(At, 1, 1); PG8_STAGE(PG8_SB(1, 0), b3, voffB); PG8_STAGE(PG8_SB(1, 1), b3 + hstepB, voffB); PG8_STAGE(PG8_SA(1, 0), a3, voffA);
            PG8_WAIT_V(8); PG8_WAIT_L(0); PG8_BAR; PG8_MMA(1, 0, At, B0); PG8_MMA(1, 1, At, B1); PG8_BAR; PG8_SCHED;
            } else {
            PG8_LDB(B0, 0, 0); PG8_SCHED; PG8_LDA(At, 0, 0); PG8_STAGE(PG8_SA(1, 1), a1 + hstepA, voffA);
            PG8_WAIT_L(8); PG8_BAR; PG8_WAIT_L(0); PG8_MMA(0, 0, At, B0); PG8_BAR; PG8_SCHED;
            PG8_LDB(B1, 0, 1); PG8_STAGE(PG8_SB(0, 0), b2, voffB);
            PG8_BAR; PG8_WAIT_L(0); PG8_MMA(0, 1, At, B1); PG8_BAR;
            PG8_LDA(At, 0, 1); PG8_STAGE(PG8_SA(0, 0), a2, voffA);
            PG8_BAR; PG8_WAIT_L(0); PG8_MMA(1, 0, At, B0); PG8_BAR; PG8_SCHED;
            PG8_STAGE(PG8_SB(0, 1), b2 + hstepB, voffB);
            PG8_WAIT_V(6); PG8_BAR; PG8_MMA(1, 1, At, B1); PG8_BAR;
            PG8_LDB(B0, 1, 0); PG8_SCHED; PG8_LDA(At, 1, 0); PG8_STAGE(PG8_SA(0, 1), a2 + hstepA, voffA);
            PG8_WAIT_L(8); PG8_BAR; PG8_WAIT_L(0); PG8_MMA(0, 0, At, B0); PG8_BAR; PG8_SCHED;
            PG8_LDB(B1, 1, 1); PG8_STAGE(PG8_SB(1, 0), b3, voffB);
            PG8_BAR; PG8_WAIT_L(0); PG8_MMA(0, 1, At, B1); PG8_BAR;
            PG8_LDA(At, 1, 1); PG8_STAGE(PG8_SA(1, 0), a3, voffA);
            PG8_BAR; PG8_WAIT_L(0); PG8_MMA(1, 0, At, B0); PG8_BAR; PG8_SCHED;
            PG8_STAGE(PG8_SB(1, 1), b3 + hstepB, voffB);
            PG8_WAIT_V(6); PG8_BAR; PG8_MMA(1, 1, At, B1); PG8_BAR;
            }
        }
        if constexpr (ALIGN_EPI) { if (wr == 0) PG8_BAR; }
        if constexpr (!Epi::AFTER_DRAIN) { E(acc, cur, wr, wc, fr, fq); }
        if (!has_next) break;
#pragma unroll
        for (int a = 0; a < 2; ++a)
#pragma unroll
            for (int b = 0; b < 2; ++b)
#pragma unroll
                for (int m = 0; m < 4; ++m)
#pragma unroll
                    for (int n = 0; n < 2; ++n) acc[a][b][m][n] = (f32x4){0.f, 0.f, 0.f, 0.f};
        cur = nxt; cA = nA; cB = nB; ++ui;
        if constexpr (ALIGN_EPI) { if (wr == 1) PG8_BAR; }
    }
    PG8_WAIT_V(0);
    if constexpr (!ALIGN_EPI) { if (wr == 0) PG8_BAR; }
    PG8_BAR;
    if constexpr (Epi::AFTER_DRAIN) { E.fused(acc, cur, wr, wc, fr, fq, lds, wid, lane); }
#undef PG8_SA
#undef PG8_SB
#undef PG8_STAGE
#undef PG8_LDA
#undef PG8_LDB
#undef PG8_MMA
#undef PG8_WAIT_V
#undef PG8_WAIT_L
#undef PG8_BAR
#undef PG8_SCHED
}
}

#define XB_TMO      128
#define XB_XCNT(j)  (256  + 64 * (j))
#define XB_XSUB(j)  (1280 + 64 * (j))
#define XB_XGEN(j)  (2304 + 64 * (j))
#define XB_TOP      3328
#define XB_TOPGEN   3392
#define XCD_BAR_WORDS 3456
#define XB_SPIN_CAP (1u << 18)
__device__ __forceinline__ unsigned xb_ld(unsigned* p)              { return __hip_atomic_load(p, __ATOMIC_RELAXED, __HIP_MEMORY_SCOPE_AGENT); }
__device__ __forceinline__ unsigned xb_add(unsigned* p, unsigned v) { return __hip_atomic_fetch_add(p, v, __ATOMIC_RELAXED, __HIP_MEMORY_SCOPE_AGENT); }
__device__ __forceinline__ unsigned xb_xcc_id() { return (unsigned)__builtin_amdgcn_s_getreg((3 << 11) | 20) & 0xFu; }
#define XB_SPIN(cond, bar) do { unsigned _sp = 0; while (cond) { __builtin_amdgcn_s_sleep(1); \
    if ((++_sp & 255u) == 0u) { if (xb_ld(&(bar)[XB_TMO])) break; if (_sp > XB_SPIN_CAP) { atomicAdd(&(bar)[XB_TMO], 1u); break; } } } } while (0)
struct XcdBarrier { unsigned* bar; unsigned x; volatile LAS unsigned* st; };
__device__ __forceinline__ XcdBarrier xcd_barrier_post(unsigned* bar, volatile LAS unsigned* st) {
    XcdBarrier b; b.bar = bar; b.x = xb_xcc_id(); b.st = st;
    if (threadIdx.x == 0) (void)xb_add(&bar[XB_XCNT(b.x)], 1u);
    return b;
}
__device__ __forceinline__ void xcd_barrier_complete(unsigned* bar, unsigned x, unsigned& nloc, unsigned& nx) {
    const unsigned G = gridDim.x * gridDim.y * gridDim.z;
    unsigned sum, cnt, mine, sp = 0u;
    for (;;) {
        sum = 0u; cnt = 0u; mine = 0u;
#pragma unroll
        for (unsigned j = 0; j < 16; ++j) { const unsigned c = xb_ld(&bar[XB_XCNT(j)]); sum += c; cnt += (c > 0u) ? 1u : 0u; mine = (j == x) ? c : mine; }
        if (sum == G) break;
        __builtin_amdgcn_s_sleep(1);
        if ((++sp & 255u) == 0u) { if (xb_ld(&bar[XB_TMO])) break; if (sp > XB_SPIN_CAP) { atomicAdd(&bar[XB_TMO], 1u); break; } }
    }
    nloc = mine > 0u ? mine : 1u; nx = cnt > 0u ? cnt : 1u;
}
__device__ __forceinline__ void xcd_barrier(const XcdBarrier& b) {
    asm volatile("s_waitcnt vmcnt(0)" ::: "memory");
    __syncthreads();
    if (threadIdx.x == 0) {
        unsigned* bar = b.bar;
        __builtin_amdgcn_s_waitcnt(0);
        unsigned nloc = b.st[0], nx = b.st[1];
        if (nloc == 0u) { xcd_barrier_complete(bar, b.x, nloc, nx); b.st[0] = nloc; b.st[1] = nx; }
        const unsigned old = xb_add(&bar[XB_XSUB(b.x)], 1u);
        const unsigned gen = old / nloc;
        if (old + 1u == (gen + 1u) * nloc) {
            __builtin_amdgcn_fence(__ATOMIC_RELEASE, "agent");
            asm volatile("s_waitcnt vmcnt(0)" ::: "memory");
            const unsigned og = xb_add(&bar[XB_TOP], 1u);
            const unsigned tg = og / nx;
            if (og + 1u == (tg + 1u) * nx) xb_add(&bar[XB_TOPGEN], 1u);
            else XB_SPIN(xb_ld(&bar[XB_TOPGEN]) == tg, bar);
            __builtin_amdgcn_fence(__ATOMIC_ACQUIRE, "agent");
            xb_add(&bar[XB_XGEN(b.x)], 1u);
            asm volatile("s_waitcnt vmcnt(0)" ::: "memory");
        } else {
            XB_SPIN(xb_ld(&bar[XB_XGEN(b.x)]) == gen, bar);
            __builtin_amdgcn_fence(__ATOMIC_ACQUIRE, "agent");
            asm volatile("s_waitcnt vmcnt(0)" ::: "memory");
        }
    }
    __syncthreads();
}

typedef const unsigned char __attribute__((address_space(4)))* kptr_t;
struct Frame {
    LAS unsigned char* lds;
    int tid, lane, wave, vcu, G;
    kptr_t ka;
};
#define KARG(T_, off) (*(T_ const __attribute__((address_space(4)))*)(F.ka + (off)))
#define FIN(k) KARG(const float*, 8 * (k))
#define FOUT KARG(float*, 144)
#define FWS KARG(unsigned char*, 152)
#define WSP(T_, off) ((T_*)(FWS + (off)))

__device__ __forceinline__ void tr_item(const float* W, int K, int N, bf16_t* WT, int row_off, const float* gain, const float* ngain, float cs, LAS float* scr, int item, int lane) {
    const int nblk = N / 32, kb = item / nblk, nb = item % nblk, k0 = 64 * kb, n0 = 32 * nb;
#pragma unroll 8
    for (int i = 0; i < 32; ++i) { const int kk = 2 * i + (lane >> 5); scr[kk * 33 + (lane & 31)] = W[(size_t)(k0 + kk) * N + n0 + (lane & 31)]; }
    LDS_WAIT(); asm volatile("" ::: "memory");
    const int c = lane & 7;
    f32x4 g0 = (f32x4){cs, cs, cs, cs}, g1 = g0;
    if (gain) { g0 = *(const f32x4*)(gain + k0 + 8 * c) * cs; g1 = *(const f32x4*)(gain + k0 + 8 * c + 4) * cs; }
#pragma unroll
    for (int j = 0; j < 4; ++j) { const int n = (lane >> 3) + 8 * j; const LAS float* s = scr + (8 * c) * 33 + n;
        const float ng = ngain ? ngain[n0 + n] : 1.f; const f32x4 h0 = g0 * ng, h1 = g1 * ng;
        u32x4 o; o.x = pk2(s[0 * 33] * h0[0], s[1 * 33] * h0[1]); o.y = pk2(s[2 * 33] * h0[2], s[3 * 33] * h0[3]); o.z = pk2(s[4 * 33] * h1[0], s[5 * 33] * h1[1]); o.w = pk2(s[6 * 33] * h1[2], s[7 * 33] * h1[3]);
        *(u32x4*)(WT + (size_t)(row_off + n0 + n) * K + k0 + 8 * c) = o; }
    LDS_WAIT(); asm volatile("" ::: "memory");
}

__device__ __forceinline__ int t5_bucket(int dist) {
    if (dist < 16) return dist;
    const float df = (float)dist;
    int large = 16 + (int)(logf(df / 16.0f) / 4.852030263919617f * 16.0f);
    return large < 31 ? large : 31;
}

__device__ __forceinline__ void p0_weights(Frame& F) {
    LAS float* scr = (LAS float*)(F.lds + F.wave * 16384);
    const int gw = F.vcu * 8 + F.wave, NGW = F.G * 8;
    constexpr int I_P = 8 * 32, I_1 = 4 * 16 * 128, I_2 = 4 * 64 * 32, I_KV = 16 * 192, I_Q = 2 * 16 * 96, I_O = 2 * 16 * 32;
    constexpr int NITEMS = I_P + I_1 + I_2 + I_KV + I_Q + I_O;
    for (int it = gw; it < NITEMS; it += NGW) {
        int r = it;
        if (r < I_P) { const int m = r / 32; tr_item(FIN(7) + (size_t)m * 65536, 256, 256, WSP(bf16_t, WS_WP) + (size_t)m * 65536, 0, nullptr, FIN(8) + m * 256, 1.f, scr, r % 32, F.lane); continue; } r -= I_P;
        if (r < I_1) { const int l = r / 2048; tr_item(FIN(10) + (size_t)l * D * FF, D, FF, WSP(bf16_t, WS_W1) + (size_t)l * D * FF, 0, FIN(9) + l * D, nullptr, 1.f, scr, r % 2048, F.lane); continue; } r -= I_1;
        if (r < I_2) { const int l = r / 2048; tr_item(FIN(11) + (size_t)l * D * FF, FF, D, WSP(bf16_t, WS_W2) + (size_t)l * D * FF, 0, nullptr, nullptr, 1.f, scr, r % 2048, F.lane); continue; } r -= I_2;
        if (r < I_KV) { tr_item(FIN(13), D, 6144, WSP(bf16_t, WS_WQKV), 0, FIN(12), nullptr, 1.f, scr, r, F.lane); continue; } r -= I_KV;
        if (r < I_Q) { const int lb = r / 1536;
            if (lb == 0) tr_item(FIN(14), D, 3072, WSP(bf16_t, WS_WQKV), 6144, FIN(6) + 2 * D, nullptr, QSCALE, scr, r % 1536, F.lane);
            else tr_item(FIN(14) + (size_t)D * 3072, D, 3072, WSP(bf16_t, WS_WQ3), 0, FIN(6) + 3 * D, nullptr, QSCALE, scr, r % 1536, F.lane);
            continue; } r -= I_Q;
        { const int lb = r / 512; tr_item(FIN(15) + (size_t)lb * D * D, D, D, WSP(bf16_t, WS_WO) + (size_t)lb * D * D, 0, nullptr, nullptr, 1.f, scr, r % 512, F.lane); }
    }
    const int gt = F.vcu * 512 + F.tid;
    if (gt < 3 * 8 * 160) {
        const int g = gt / 1280, h = (gt / 160) % 8, u = gt % 160, dist = 144 - u;
        float v = -1e30f;
        if (dist >= 0 && dist <= 128) v = FIN(16)[t5_bucket(dist << (2 * g)) * 24 + g * 8 + h] * LOG2E;
        WSP(float, WS_BIAS)[gt] = v;
    }
}

__device__ __forceinline__ void pooled_phase(Frame& F, int l) {
    const float* X = l == 0 ? FIN(0) : WSP(float, WS_X);
    const float* rs = WSP(float, WS_RSB);
    const float* gain = FIN(6) + l * D;
    bf16_t* PL = WSP(bf16_t, WS_PL);
    LAS float* rinv_s = (LAS float*)(F.lds + AUX_OFF);
    for (int item = F.vcu; item < 512; item += F.G) {
        const int b = item >> 7, t0 = (item & 127) * 32;
        if (l == 0) {
            for (int i = F.wave; i < 47; i += 8) { const int t = t0 - 15 + i;
                if (t >= 0) { const f32x4* xr = (const f32x4*)(X + (size_t)(b * T + t) * D) + F.lane; float s = 0.f;
#pragma unroll
                    for (int j = 0; j < 4; ++j) { const f32x4 v = xr[64 * j]; s += (v[0] * v[0] + v[1] * v[1]) + (v[2] * v[2] + v[3] * v[3]); }
                    s = wave_sum(s); if (F.lane == 0) rinv_s[i] = 1.0f / sqrtf(s * (1.0f / D) + EPS); } }
        } else if (F.tid < 47) { const int t = t0 - 15 + F.tid;
            if (t >= 0) { const int r = b * T + t; const float ss = (rs[r] + rs[M + r]) + (rs[2 * M + r] + rs[3 * M + r]); rinv_s[F.tid] = 1.0f / sqrtf(ss * (1.0f / D) + EPS); } }
        __syncthreads();
        const int cq = F.tid & 255, half = F.tid >> 8, grp = cq >> 6, w = 2 << grp, ts = t0 + 16 * half;
        const f32x4 g4 = *(const f32x4*)(gain + 4 * cq);
        const float* xcol = X + (size_t)b * T * D + 4 * cq;
        f32x4 S = (f32x4){0.f, 0.f, 0.f, 0.f};
        for (int i = 1; i < w; ++i) { const int t = ts - i; if (t >= 0) S += *(const f32x4*)(xcol + (size_t)t * D) * rinv_s[t - t0 + 15]; }
#pragma unroll 4
        for (int i = 0; i < 16; ++i) {
            const int t = ts + i;
            const f32x4 a = *(const f32x4*)(xcol + (size_t)t * D) * rinv_s[t - t0 + 15];
            S += a;
            const int cnt = (t + 1) < w ? (t + 1) : w;
            const f32x4 p = (S * (1.0f / (float)cnt) - a) * g4;
            u32x2 o; o.x = pk2(p[0], p[1]); o.y = pk2(p[2], p[3]);
            *(u32x2*)(PL + (size_t)(b * T + t) * D + 4 * cq) = o;
            if (t >= T - 15) *(f32x4*)(FOUT + OUT_PP + ((size_t)(l * NB + b) * 15 + (t - (T - 15))) * D + 4 * cq) = a * g4;
            const int tr = t - w + 1;
            if (tr >= 0) S -= *(const f32x4*)(xcol + (size_t)tr * D) * rinv_s[tr - t0 + 15];
        }
        __syncthreads();
    }
    const float* Xs = l == 0 ? FIN(1) : (const float*)(FWS + WS_SMP + SM_XBF);
    LAS float* red = (LAS float*)(F.lds + AUX_OFF + 256);
    for (int b = F.vcu; b < SB; b += F.G) {
        f32x4 xv = (f32x4){0.f, 0.f, 0.f, 0.f};
        if (F.tid < 256) xv = *(const f32x4*)(Xs + (size_t)b * D + 4 * F.tid);
        float s = (xv[0] * xv[0] + xv[1] * xv[1]) + (xv[2] * xv[2] + xv[3] * xv[3]);
        s = wave_sum(s); if (F.lane == 0) red[F.wave] = s;
        __syncthreads();
        const float tot = (red[0] + red[1]) + (red[2] + red[3]);
        const float rinv = 1.0f / sqrtf(tot * (1.0f / D) + EPS);
        if (F.tid < 256) {
            const int cq = F.tid, grp = cq >> 6, w = 2 << grp;
            const f32x4 hv = xv * rinv * *(const f32x4*)(gain + 4 * cq);
            const float* st = FIN(2) + ((size_t)(l * SB + b) * 15) * D + 4 * cq;
            float* po = FOUT + OUT_PS + ((size_t)(l * SB + b) * 15) * D + 4 * cq;
            f32x4 S = hv;
            for (int i = 0; i < 15; ++i) { const f32x4 sv = *(const f32x4*)(st + (size_t)i * D);
                if (i >= 16 - w) S += sv;
                if (i >= 1) *(f32x4*)(po + (size_t)(i - 1) * D) = sv; }
            *(f32x4*)(po + (size_t)14 * D) = hv;
            const f32x4 p = S * (1.0f / (float)w) - hv;
            u32x2 o; o.x = pk2(p[0], p[1]); o.y = pk2(p[2], p[3]);
            *(u32x2*)((bf16_t*)(FWS + WS_SMP + SM_PL) + (size_t)b * D + 4 * cq) = o;
        }
        __syncthreads();
    }
}

template <class MEpi>
__device__ __forceinline__ void mini_gemm(Frame& F, const bf16_t* A, int lda, int acol256, const bf16_t* Bt, int ldb, int N, int K, const MEpi& E) {
    LAS f32x4* red = (LAS f32x4*)F.lds;
    const int fr = F.lane & 15, fq = F.lane >> 4, kper = K / 8, kbeg = F.wave * kper;
    for (int u = F.vcu; u < N / 16; u += F.G) {
        const int n0 = 16 * u;
        f32x4 acc0 = (f32x4){0.f, 0.f, 0.f, 0.f}, acc1 = acc0;
        const bf16_t* bp = Bt + (size_t)(n0 + fr) * ldb + kbeg + 8 * fq;
        const bf16_t* ap0 = A + (size_t)fr * lda + (n0 >> 8) * acol256 + kbeg + 8 * fq;
        const bf16_t* ap1 = ap0 + (size_t)16 * lda;
#pragma unroll 4
        for (int k = 0; k < kper; k += 32) {
            const bf16x8 bv = *(const bf16x8*)(bp + k), a0 = *(const bf16x8*)(ap0 + k), a1 = *(const bf16x8*)(ap1 + k);
            acc0 = __builtin_amdgcn_mfma_f32_16x16x32_bf16(bv, a0, acc0, 0, 0, 0);
            acc1 = __builtin_amdgcn_mfma_f32_16x16x32_bf16(bv, a1, acc1, 0, 0, 0);
        }
        red[(F.wave * 2 + 0) * 64 + F.lane] = acc0; red[(F.wave * 2 + 1) * 64 + F.lane] = acc1;
        __syncthreads();
        if (F.tid < 128) { const int rt = F.tid >> 6, ln = F.tid & 63; f32x4 s = (f32x4){0.f, 0.f, 0.f, 0.f};
#pragma unroll
            for (int w = 0; w < 8; ++w) s += red[(w * 2 + rt) * 64 + ln];
            E(16 * rt + (ln & 15), n0 + 4 * (ln >> 4), s); }
        __syncthreads();
    }
}
struct MEpi {
    int mode; const float* base; float* out; bf16_t* xb; const LAS float* rowscale; bf16_t* hid; float* qs; float* dout; int coloff;
    __device__ __forceinline__ void operator()(int row, int col0, f32x4 v) const {
        if (mode == 0) {
            if (rowscale) v = v * rowscale[row];
            v += *(const f32x4*)(base + (size_t)row * D + col0);
            *(f32x4*)(out + (size_t)row * D + col0) = v;
            u32x2 o; o.x = pk2(v[0], v[1]); o.y = pk2(v[2], v[3]); *(u32x2*)(xb + (size_t)row * D + col0) = o;
        } else if (mode == 1) {
            v = __builtin_elementwise_max(v, (f32x4){0.f, 0.f, 0.f, 0.f}); v = v * v;
            u32x2 o; o.x = pk2(v[0], v[1]); o.y = pk2(v[2], v[3]); *(u32x2*)(hid + (size_t)row * FF + col0) = o;
        } else {
            v = v * rowscale[row]; const int col = col0 + coloff;
            if (col < 6144) { const int g = col >> 11, kvsel = (col >> 10) & 1, hd = col & 1023;
                const size_t o = g == 0 ? OUT_KV128S : (g == 1 ? OUT_KV512S : OUT_KV2048S);
                *(f32x4*)(dout + o + (size_t)row * 2048 + kvsel * 1024 + hd) = v;
            } else *(f32x4*)(qs + (size_t)row * 3072 + (col - 6144)) = v;
        }
    }
};
__device__ __forceinline__ void sample_rowscale(Frame& F, const float* Xs, LAS float* dst, int mode) {
    for (int r = F.wave * 4; r < F.wave * 4 + 4; ++r) { const f32x4* xr = (const f32x4*)(Xs + (size_t)r * D) + F.lane; float s = 0.f;
#pragma unroll
        for (int j = 0; j < 4; ++j) { const f32x4 v = xr[64 * j]; s += (v[0] * v[0] + v[1] * v[1]) + (v[2] * v[2] + v[3] * v[3]); }
        s = wave_sum(s); const float ms = s * (1.0f / D) + EPS;
        if (F.lane == 0) dst[r] = mode == 1 ? 1.0f / sqrtf(ms) : 1.0f / ms; }
    __syncthreads();
}

__device__ __forceinline__ void sample_attn(Frame& F) {
    LAS float* sq = (LAS float*)F.lds;
    LAS float* sc = sq + 384;
    LAS float* wred = sc + 512;
    LAS float* part = wred + 16;
    const float* Qs = (const float*)(FWS + WS_SMP + SM_Q);
    const float* tbl = WSP(float, WS_BIAS);
    bf16_t* Os = (bf16_t*)(FWS + WS_SMP + SM_O);
    for (int item = F.vcu; item < SB * NH; item += F.G) {
        const int b = item >> 3, h = item & 7;
        if (F.tid < 384) sq[F.tid] = Qs[(size_t)b * 3072 + (F.tid >> 7) * 1024 + h * HD + (F.tid & 127)];
        __syncthreads();
        float s = -1e30f;
        if (F.tid < 387) {
            const int g = F.tid / 129, j = F.tid % 129, L = 128 << (2 * g);
            const float* kp;
            if (j == 0) kp = FOUT + (g == 0 ? OUT_KV128S : (g == 1 ? OUT_KV512S : OUT_KV2048S)) + (size_t)b * 2048 + h * HD;
            else kp = (g == 0 ? FIN(3) : (g == 1 ? FIN(4) : FIN(5))) + ((size_t)(b * L + (L - (j << (2 * g)))) * 2 + 0) * 1024 + h * HD;
            float a = 0.f;
#pragma unroll 8
            for (int d4 = 0; d4 < 32; ++d4) { const f32x4 kv = *(const f32x4*)(kp + 4 * d4); const LAS float* q = sq + g * 128 + 4 * d4; a += (kv[0] * q[0] + kv[1] * q[1]) + (kv[2] * q[2] + kv[3] * q[3]); }
            s = a + tbl[(g * 8 + h) * 160 + 144 - j];
        }
        float mx = wave_max(s); if (F.lane == 0) wred[F.wave] = mx;
        __syncthreads();
        mx = fmaxf(fmaxf(fmaxf(wred[0], wred[1]), fmaxf(wred[2], wred[3])), fmaxf(fmaxf(wred[4], wred[5]), fmaxf(wred[6], wred[7])));
        const float p = F.tid < 387 ? exp2f(s - mx) : 0.f;
        sc[F.tid] = p;
        float sm = wave_sum(p); if (F.lane == 0) wred[8 + F.wave] = sm;
        __syncthreads();
        const float tot = ((wred[8] + wred[9]) + (wred[10] + wred[11])) + ((wred[12] + wred[13]) + (wred[14] + wred[15]));
        const int d = F.tid & 127, pt = F.tid >> 7;
        float acc = 0.f;
#pragma unroll 4
        for (int kk = pt; kk < 387; kk += 4) {
            const int g = kk / 129, j = kk % 129, L = 128 << (2 * g);
            const float* vp;
            if (j == 0) vp = FOUT + (g == 0 ? OUT_KV128S : (g == 1 ? OUT_KV512S : OUT_KV2048S)) + (size_t)b * 2048 + 1024 + h * HD;
            else vp = (g == 0 ? FIN(3) : (g == 1 ? FIN(4) : FIN(5))) + ((size_t)(b * L + (L - (j << (2 * g)))) * 2 + 1) * 1024 + h * HD;
            acc += sc[kk] * vp[d];
        }
        part[pt * 128 + d] = acc;
        __syncthreads();
        if (F.tid < 128) { const float o = ((part[d] + part[128 + d]) + (part[256 + d] + part[384 + d])) / tot; Os[(size_t)b * D + h * HD + d] = (bf16_t)f2bf(o); }
        __syncthreads();
    }
}

__device__ __forceinline__ bf16x4 tr_read(unsigned addr) { bf16x4 r; asm volatile("ds_read_b64_tr_b16 %0, %1" : "=v"(r) : "v"(addr) : "memory"); return r; }
template <int STAGE>
__device__ __forceinline__ void attn_phase(Frame& F) {
    const bf16_t* QA = WSP(bf16_t, WS_QA); const bf16_t* KA = WSP(bf16_t, WS_KA); const bf16_t* VA = WSP(bf16_t, WS_VA);
    bf16_t* OG = WSP(bf16_t, WS_OG); float* LG = WSP(float, WS_LG); bf16_t* O = WSP(bf16_t, WS_PL);
    const float* tblg = WSP(float, WS_BIAS);
    LAS unsigned char* Kt = F.lds; LAS unsigned char* Vt = F.lds + 65536;
    LAS float* tbl = (LAS float*)(F.lds + AUX_OFF);
    const int fr = F.lane & 15, fq = F.lane >> 4, w = F.wave;
    const int nunits = STAGE == 0 ? 2048 : 1024;
    for (int ui = F.vcu; ui < nunits; ui += F.G) {
        int g, rem;
        if (STAGE == 0) { g = 1 + (ui >> 10); rem = ui & 1023; } else { g = 0; rem = ui; }
        const int bh = rem >> 5, j = rem & 31;
        const int dsh = 2 * g, Ls = T >> dsh;
        const bool first = ((128 * j) & (Ls - 1)) == 0;
        const size_t seqbase = (size_t)(g * 32 + bh) * T;
#pragma unroll
        for (int i = 0; i < 8; ++i) {
            const int ci = F.tid + 512 * i, row = ci >> 4, ch = ci & 15;
            const int slot = first ? 128 * j + (row & 127) : 128 * j - 128 + row;
            const u32x4 kv = *(const u32x4*)(KA + (seqbase + slot) * HD + ch * 8);
            const u32x4 vv = *(const u32x4*)(VA + (seqbase + slot) * HD + ch * 8);
            *(LAS u32x4*)(Kt + row * 256 + ((ch ^ (row & 15)) << 4)) = kv;
            *(LAS u32x4*)(Vt + row * 256 + ((ch ^ ((row & 7) << 1)) << 4)) = vv;
        }
        if (F.tid < 160) tbl[F.tid] = tblg[(g * 8 + (bh & 7)) * 160 + F.tid];
        bf16x8 qf[4];
        { const bf16_t* qp = QA + (seqbase + 128 * j + 16 * w + fr) * HD + 8 * fq;
#pragma unroll
          for (int ks = 0; ks < 4; ++ks) qf[ks] = *(const bf16x8*)(qp + 32 * ks); }
        __syncthreads();
        f32x4 s[9];
#pragma unroll
        for (int kt = 0; kt < 9; ++kt) {
            f32x4 a = (f32x4){0.f, 0.f, 0.f, 0.f};
            const int row = 16 * w + 16 * kt + fr;
#pragma unroll
            for (int ks = 0; ks < 4; ++ks) {
                const bf16x8 kf = *(const LAS bf16x8*)(Kt + row * 256 + (((4 * ks + fq) ^ fr) << 4));
                a = __builtin_amdgcn_mfma_f32_16x16x32_bf16(kf, qf[ks], a, 0, 0, 0);
            }
            s[kt] = a;
        }
        float mx = -1e30f;
#pragma unroll
        for (int kt = 0; kt < 9; ++kt) {
            const bool dead = first && (kt < 8 - w);
#pragma unroll
            for (int r = 0; r < 4; ++r) { float v = s[kt][r] + tbl[16 * kt + r + 4 * fq - fr + 16]; v = dead ? -1e30f : v; s[kt][r] = v; mx = fmaxf(mx, v); }
        }
        mx = fmaxf(mx, __shfl_xor(mx, 16)); mx = fmaxf(mx, __shfl_xor(mx, 32));
        float l = 0.f;
#pragma unroll
        for (int kt = 0; kt < 9; ++kt)
#pragma unroll
            for (int r = 0; r < 4; ++r) { const float p = exp2f(s[kt][r] - mx); s[kt][r] = p; l += p; }
        l += __shfl_xor(l, 16); l += __shfl_xor(l, 32);
        bf16x8 pf[4]; bf16x4 pl;
#pragma unroll
        for (int i = 0; i < 4; ++i) { u32x4 t; t.x = pg8::cvt_pk_bf16(s[2 * i][0], s[2 * i][1]); t.y = pg8::cvt_pk_bf16(s[2 * i][2], s[2 * i][3]); t.z = pg8::cvt_pk_bf16(s[2 * i + 1][0], s[2 * i + 1][1]); t.w = pg8::cvt_pk_bf16(s[2 * i + 1][2], s[2 * i + 1][3]);
            pf[i] = __builtin_bit_cast(bf16x8, t); }
        { u32x2 t; t.x = pg8::cvt_pk_bf16(s[8][0], s[8][1]); t.y = pg8::cvt_pk_bf16(s[8][2], s[8][3]); pl = __builtin_bit_cast(bf16x4, t); }
        const unsigned vbase = (unsigned)(size_t)Vt;
        const int q4 = (F.lane & 15) >> 2, p4 = F.lane & 3;
        f32x4 o[8];
#pragma unroll
        for (int dt = 0; dt < 8; ++dt) {
            f32x4 a = (f32x4){0.f, 0.f, 0.f, 0.f};
#pragma unroll
            for (int i = 0; i < 4; ++i) {
                const int r0 = 16 * w + 32 * i + 4 * fq + q4, r1 = r0 + 16;
                const bf16x4 v0 = tr_read(vbase + r0 * 256 + (((2 * dt + (p4 >> 1)) ^ ((r0 & 7) << 1)) << 4) + 8 * (p4 & 1));
                const bf16x4 v1 = tr_read(vbase + r1 * 256 + (((2 * dt + (p4 >> 1)) ^ ((r1 & 7) << 1)) << 4) + 8 * (p4 & 1));
                asm volatile("s_waitcnt lgkmcnt(0)" ::: "memory"); __builtin_amdgcn_sched_barrier(0);
                bf16x8 vf; vf[0] = v0[0]; vf[1] = v0[1]; vf[2] = v0[2]; vf[3] = v0[3]; vf[4] = v1[0]; vf[5] = v1[1]; vf[6] = v1[2]; vf[7] = v1[3];
                a = __builtin_amdgcn_mfma_f32_16x16x32_bf16(vf, pf[i], a, 0, 0, 0);
            }
            { const int r0 = 16 * w + 128 + 4 * fq + q4;
              const bf16x4 v0 = tr_read(vbase + r0 * 256 + (((2 * dt + (p4 >> 1)) ^ ((r0 & 7) << 1)) << 4) + 8 * (p4 & 1));
              asm volatile("s_waitcnt lgkmcnt(0)" ::: "memory"); __builtin_amdgcn_sched_barrier(0);
              a = __builtin_amdgcn_mfma_f32_16x16x16bf16_1k(v0, pl, a, 0, 0, 0); }
            o[dt] = a;
        }
        const float inv = 1.0f / l, lse = mx + log2f(l);
        const int slot = 128 * j + 16 * w + fr;
        const int t = ((slot & (Ls - 1)) << dsh) + (slot >> (12 - dsh));
        if (STAGE == 0) {
            bf16_t* op = OG + ((size_t)((g - 1) * 32 + bh) * T + t) * HD + 4 * fq;
#pragma unroll
            for (int dt = 0; dt < 8; ++dt) { u32x2 wv; wv.x = pg8::cvt_pk_bf16(o[dt][0] * inv, o[dt][1] * inv); wv.y = pg8::cvt_pk_bf16(o[dt][2] * inv, o[dt][3] * inv); *(u32x2*)(op + 16 * dt) = wv; }
            if (fq == 0) LG[(size_t)((g - 1) * 32 + bh) * T + t] = lse;
        } else {
            const float l1 = LG[(size_t)bh * T + t], l2 = LG[(size_t)(32 + bh) * T + t];
            const float mm = fmaxf(lse, fmaxf(l1, l2));
            float w0 = exp2f(lse - mm), w1 = exp2f(l1 - mm), w2 = exp2f(l2 - mm);
            const float wi = 1.0f / (w0 + w1 + w2); w0 *= wi * inv; w1 *= wi; w2 *= wi;
            const bf16_t* o1 = OG + ((size_t)bh * T + t) * HD + 4 * fq; const bf16_t* o2 = OG + ((size_t)(32 + bh) * T + t) * HD + 4 * fq;
            bf16_t* op = O + ((size_t)((bh >> 3) * T + t)) * D + (bh & 7) * HD + 4 * fq;
#pragma unroll
            for (int dt = 0; dt < 8; ++dt) { const u32x2 a1 = *(const u32x2*)(o1 + 16 * dt), a2 = *(const u32x2*)(o2 + 16 * dt);
                const float r0 = o[dt][0] * w0 + bflo(a1.x) * w1 + bflo(a2.x) * w2, r1 = o[dt][1] * w0 + bfhi(a1.x) * w1 + bfhi(a2.x) * w2;
                const float r2 = o[dt][2] * w0 + bflo(a1.y) * w1 + bflo(a2.y) * w2, r3 = o[dt][3] * w0 + bfhi(a1.y) * w1 + bfhi(a2.y) * w2;
                u32x2 wv; wv.x = pg8::cvt_pk_bf16(r0, r1); wv.y = pg8::cvt_pk_bf16(r2, r3); *(u32x2*)(op + 16 * dt) = wv; }
        }
        __syncthreads();
    }
}

__device__ __forceinline__ void final_phase(Frame& F) {
    const float* g = FIN(17);
    const int gw = F.vcu * 8 + F.wave, NGW = F.G * 8;
    for (int m = gw; m < M + SB; m += NGW) {
        const float* xr = m < M ? WSP(float, WS_X) + (size_t)m * D : (const float*)(FWS + WS_SMP + SM_XBF) + (size_t)(m - M) * D;
        float* yr = m < M ? FOUT + OUT_Y + (size_t)m * D : FOUT + OUT_YS + (size_t)(m - M) * D;
        f32x4 v[4]; float s = 0.f;
#pragma unroll
        for (int j = 0; j < 4; ++j) { v[j] = *((const f32x4*)xr + F.lane + 64 * j); s += (v[j][0] * v[j][0] + v[j][1] * v[j][1]) + (v[j][2] * v[j][2] + v[j][3] * v[j][3]); }
        const float rinv = 1.0f / sqrtf(wave_sum(s) * (1.0f / D) + EPS);
#pragma unroll
        for (int j = 0; j < 4; ++j) *((f32x4*)yr + F.lane + 64 * j) = v[j] * rinv * *((const f32x4*)g + F.lane + 64 * j);
    }
}

struct Args { const float* in[18]; float* out; unsigned char* ws; int ph_lo, ph_hi, li, pad; };

__global__ void __launch_bounds__(512, 2) mk_fwd(Args args) {
    extern __shared__ __attribute__((aligned(16))) unsigned char lds_raw[];
    Frame F;
    F.lds = (LAS unsigned char*)lds_raw;
    F.tid = threadIdx.x; F.lane = F.tid & 63; F.wave = __builtin_amdgcn_readfirstlane(F.tid >> 6);
    F.G = gridDim.x; { const int bx = blockIdx.x; F.vcu = (F.G % 8 == 0) ? (bx % 8) * (F.G / 8) + bx / 8 : bx; }
    F.ka = (kptr_t)__builtin_amdgcn_kernarg_segment_ptr();
    volatile LAS unsigned* MISC = (volatile LAS unsigned*)(F.lds + MISC_OFF);
    for (int u = F.tid; u < (LDS_BYTES - LDSCTL_OFF) / 4; u += 512) ((LAS unsigned*)(F.lds + LDSCTL_OFF))[u] = 0u;
    __syncthreads();
    XcdBarrier bar; bar.bar = (unsigned*)(FWS + WS_CTL) + CW_BAR; bar.x = 0; bar.st = nullptr;
    if (!MK_PER_PHASE) bar = xcd_barrier_post((unsigned*)(FWS + WS_CTL) + CW_BAR, MISC + 8);

    for (int ph = args.ph_lo; ph < args.ph_hi; ++ph) {
        { kptr_t ka = (kptr_t)__builtin_amdgcn_kernarg_segment_ptr(); asm volatile("" : "+s"(ka)); F.ka = ka; }
        { int tid = threadIdx.x; asm volatile("" : "+v"(tid)); F.tid = tid; F.lane = tid & 63; F.wave = __builtin_amdgcn_readfirstlane(tid >> 6); }
        unsigned char* smp = FWS + WS_SMP;
        float* XsA = (float*)(smp + SM_XA); float* XsB = (float*)(smp + SM_XBF); bf16_t* XBs = (bf16_t*)(smp + SM_XBB);
        bf16_t* PLs = (bf16_t*)(smp + SM_PL); bf16_t* HIDs = (bf16_t*)(smp + SM_HID); float* Qs = (float*)(smp + SM_Q); bf16_t* Os = (bf16_t*)(smp + SM_O);
        LAS float* rsc = (LAS float*)(F.lds + AUX_OFF + 1024);
        int kind, l;
        if (ph == 0) { kind = 0; l = 0; }
        else if (ph <= 3) { kind = ph; l = 0; }
        else if (ph == 4) { kind = 4; l = 1; }
        else if (ph <= 7) { kind = ph - 4; l = 1; }
        else if (ph == 20) { kind = 9; l = 3; }
        else { const int q = ph - 8; l = 2 + q / 6; const int r = q % 6; kind = r == 0 ? 5 : (r == 1 ? 6 : (r == 2 ? 7 : (r == 3 ? 8 : (r == 4 ? 2 : 3)))); }

        if (KON(8) && (kind == 1 || kind == 2 || kind == 3 || kind == 5 || kind == 8)) {
            MEpi ME; ME.mode = kind == 2 ? 1 : (kind == 5 ? 2 : 0);
            ME.base = kind == 3 ? XsA : ((kind == 1 && l == 0) ? FIN(1) : XsB); ME.out = kind == 3 ? XsB : XsA; ME.xb = XBs;
            ME.rowscale = (kind == 3 || kind == 5) ? rsc : nullptr; ME.hid = HIDs; ME.qs = Qs; ME.dout = FOUT; ME.coloff = l == 2 ? 0 : 6144;
            const bf16_t* A; const bf16_t* Bt; int lda, acol = 0, ldb, N, K;
            if (kind == 1) { A = PLs; lda = D; acol = 256; Bt = WSP(bf16_t, WS_WP) + (size_t)l * D * 256; ldb = 256; N = D; K = 256; }
            else if (kind == 2) { A = XBs; lda = D; Bt = WSP(bf16_t, WS_W1) + (size_t)l * D * FF; ldb = D; N = FF; K = D; }
            else if (kind == 3) { A = HIDs; lda = FF; Bt = WSP(bf16_t, WS_W2) + (size_t)l * D * FF; ldb = FF; N = D; K = FF; }
            else if (kind == 5) { A = XBs; lda = D; Bt = l == 2 ? WSP(bf16_t, WS_WQKV) : WSP(bf16_t, WS_WQ3); ldb = D; N = l == 2 ? NQKV : 3072; K = D; }
            else { A = Os; lda = D; Bt = WSP(bf16_t, WS_WO) + (size_t)(l - 2) * D * D; ldb = D; N = D; K = D; }
            if (kind == 3 || kind == 5) sample_rowscale(F, kind == 3 ? XsA : XsB, rsc, kind == 3 ? 2 : 1);
            mini_gemm(F, A, lda, acol, Bt, ldb, N, K, ME);
        }
        if (KON(0) && kind == 0) { p0_weights(F); pooled_phase(F, 0); }
        else if (KON(4) && kind == 4) { pooled_phase(F, l); }
        else if (KON(1) && (kind == 1 || kind == 8 || kind == 3)) {
            pg8::Gemm g;
            if (kind == 1) g = pg8::Gemm{WSP(bf16_t, WS_PL), WSP(bf16_t, WS_WP) + (size_t)l * D * 256, M, D, 256, D, 256, 256};
            else if (kind == 8) g = pg8::Gemm{WSP(bf16_t, WS_PL), WSP(bf16_t, WS_WO) + (size_t)(l - 2) * D * D, M, D, D, D, D, 0};
            else g = pg8::Gemm{WSP(bf16_t, WS_HID), WSP(bf16_t, WS_W2) + (size_t)l * D * FF, M, D, FF, FF, FF, 0};
            pg8::StaticOrder S; S.init(M, D, F.G, (int)blockIdx.x);
            pg8::EpiRes E{(kind == 1 && l == 0) ? FIN(0) : WSP(float, WS_X), WSP(float, WS_X), WSP(bf16_t, WS_XB), kind == 3 ? WSP(float, WS_RSA) : nullptr, kind == 3 ? WSP(float, WS_RSB) : WSP(float, WS_RSA)};
            if (F.G == 256) pg8::gemm_phase<pg8::EpiRes, pg8::StaticOrder, false, true>(F.lds, F.tid, g, S, E);
        }
        else if (KON(2) && kind == 2) {
            pg8::Gemm g{WSP(bf16_t, WS_XB), WSP(bf16_t, WS_W1) + (size_t)l * D * FF, M, FF, D, D, D, 0};
            pg8::StaticOrder S; S.init(M, FF, F.G, (int)blockIdx.x);
            pg8::EpiRelu2 E{WSP(bf16_t, WS_HID), FF};
            pg8::gemm_phase<pg8::EpiRelu2, pg8::StaticOrder, true, true>(F.lds, F.tid, g, S, E);
        }
        else if (KON(5) && kind == 5) {
            const bf16_t* Wt = l == 2 ? WSP(bf16_t, WS_WQKV) : WSP(bf16_t, WS_WQ3);
            const int N = l == 2 ? NQKV : 3072;
            pg8::Gemm g{WSP(bf16_t, WS_XB), Wt, M, N, D, D, D, 0};
            pg8::StaticOrder S; S.init(M, N, F.G, (int)blockIdx.x);
            pg8::EpiQKV E{WSP(float, WS_RSB), FWS, FOUT, l == 2 ? 0 : 24};
            pg8::gemm_phase<pg8::EpiQKV, pg8::StaticOrder, true, true>(F.lds, F.tid, g, S, E);
        }
        else if (KON(6) && kind == 6) { sample_attn(F); attn_phase<0>(F); }
        else if (KON(7) && kind == 7) { attn_phase<1>(F); }
        else if (KON(9) && kind == 9) { final_phase(F); }

        if (ph + 1 < args.ph_hi) xcd_barrier(bar);
    }
}

extern "C" void kernel_launch(void* const* d_in, const int* in_sizes, int n_in, void* d_out, int out_size, void* d_ws, size_t ws_size, hipStream_t stream) {
    static int grid = 0;
    if (grid == 0) {
        if (n_in != 18 || out_size != (int)OUT_TOTAL || ws_size < WS_END) { fprintf(stderr, "kernel_launch: unexpected shapes: n_in %d out %d ws %zu\n", n_in, out_size, ws_size); grid = -1; return; }
        int dev = 0, cus = 0, per_cu = 0;
        if (hipGetDevice(&dev) != hipSuccess || hipDeviceGetAttribute(&cus, hipDeviceAttributeMultiprocessorCount, dev) != hipSuccess) { grid = -1; return; }
        if (hipFuncSetAttribute((const void*)mk_fwd, hipFuncAttributeMaxDynamicSharedMemorySize, LDS_BYTES) != hipSuccess) { fprintf(stderr, "kernel_launch: hipFuncSetAttribute failed\n"); grid = -1; return; }
        if (hipOccupancyMaxActiveBlocksPerMultiprocessor(&per_cu, (const void*)mk_fwd, 512, LDS_BYTES) != hipSuccess || per_cu < 1) { fprintf(stderr, "kernel_launch: occupancy query reports %d blocks per CU\n", per_cu); (void)hipGetLastError(); grid = -1; return; }
        grid = cus;
        if (grid != 256) fprintf(stderr, "kernel_launch: %d CUs; this kernel is built for 256\n", grid);
    }
    if (grid < 0) return;
    (void)hipMemsetAsync((char*)d_ws + WS_CTL, 0, CTL_ZERO_BYTES, stream);
    Args a{};
    for (int i = 0; i < 18; ++i) a.in[i] = (const float*)d_in[i];
    a.out = (float*)d_out; a.ws = (unsigned char*)d_ws;
#if MK_PER_PHASE
    for (int ph = 0; ph < NPHASE; ++ph) { a.ph_lo = ph; a.ph_hi = ph + 1; a.li = ph; hipLaunchKernelGGL(mk_fwd, dim3(grid), dim3(512), LDS_BYTES, stream, a); }
#else
    a.ph_lo = 0; a.ph_hi = NPHASE; a.li = 0;
    hipLaunchKernelGGL(mk_fwd, dim3(grid), dim3(512), LDS_BYTES, stream, a);
#endif
}
```
